# Optimizing an MI355X kernel written in HIP

```python
import math
import jax, jax.numpy as jnp
from jax import lax
import numpy as np

D_MODEL = 1024
BATCH = 8
SEQ = 2048
DEPTH = 1
DEC_BATCH = 128
DEC_SEQ = 8
PAST_LEN = 16384
PAGE_SIZE = 128

CHUNK = 128
D_A = D_MODEL
A_GROUPS = 8
A_GROUP_DIM = D_A // A_GROUPS
EXPAND = 2
D_INNER = EXPAND * D_MODEL
SSD_HEAD_DIM = 64
SSD_HEADS = D_INNER // SSD_HEAD_DIM
SSD_GROUPS = 8
SSD_STATE = 128
CONV_W = 4
CONV_DIM = D_INNER + 2 * SSD_GROUPS * SSD_STATE
SSD_CHUNK = 128
N_MEM = 256
X_HEADS = 4
X_HEAD_DIM = 128
D_X = X_HEADS * X_HEAD_DIM
N_BRANCH = 3
EPS = 1e-6
IN_SIZES = (D_A, D_A, D_A, D_INNER, CONV_DIM, SSD_HEADS, D_X, D_X, N_BRANCH * D_MODEL)
IN_DIM = sum(IN_SIZES)

kernel_name = "hybrid_gmlp_ssd_memattn_step"


def _split_points(sizes):
    pts, acc = [], 0
    for s in sizes[:-1]:
        acc += s
        pts.append(acc)
    return pts


def _rmsnorm(x, g):
    xf = x.astype(jnp.float32)
    xf = xf * lax.rsqrt(jnp.mean(xf * xf, axis=-1, keepdims=True) + EPS)
    return (xf * g.astype(jnp.float32)).astype(x.dtype)


def _layernorm(x, g, b):
    xf = x.astype(jnp.float32)
    mu = jnp.mean(xf, axis=-1, keepdims=True)
    xc = xf - mu
    xf = xc * lax.rsqrt(jnp.mean(xc * xc, axis=-1, keepdims=True) + EPS)
    return (xf * g.astype(jnp.float32) + b.astype(jnp.float32)).astype(x.dtype)


def _gated_group_rmsnorm(y, z, g):
    yf = (y * jax.nn.silu(z)).astype(jnp.float32)
    sh = yf.shape
    yg = yf.reshape(sh[:-1] + (SSD_GROUPS, D_INNER // SSD_GROUPS))
    yg = yg * lax.rsqrt(jnp.mean(yg * yg, axis=-1, keepdims=True) + EPS)
    return (yg.reshape(sh) * g.astype(jnp.float32)).astype(y.dtype)


def _gmlp_spatial(v, w_s, b_s):
    bsz, L, _ = v.shape
    n_c = -(-L // CHUNK)
    pad = n_c * CHUNK - L
    vp = jnp.pad(v, ((0, 0), (0, pad), (0, 0)))
    vr = vp.reshape(bsz, n_c, CHUNK, A_GROUPS, A_GROUP_DIM)
    mask = jnp.tril(jnp.ones((CHUNK, CHUNK), dtype=bool))
    w = jnp.where(mask[None], w_s, jnp.zeros_like(w_s))
    s = jnp.einsum('gts,bcsgd->bctgd', w, vr) + b_s.T[None, None, :, :, None]
    return s.reshape(bsz, n_c * CHUNK, D_A)[:, :L]


def _causal_conv(xbc, conv_state, w, b):
    L = xbc.shape[1]
    xpad = jnp.concatenate([conv_state.astype(xbc.dtype), xbc], axis=1)
    out = b + sum(xpad[:, k:k + L, :] * w[k] for k in range(CONV_W))
    return jax.nn.silu(out), xpad[:, -(CONV_W - 1):, :]


def _segsum_decay(a_cs):
    q = a_cs.shape[-1]
    diff = a_cs[..., :, None] - a_cs[..., None, :]
    mask = jnp.tril(jnp.ones((q, q), dtype=bool))
    return jnp.exp(jnp.where(mask, diff, -jnp.inf))


def _ssd(x, dt, a, b_in, c_in, h0):
    f32 = jnp.float32
    bsz, L = x.shape[:2]
    q = min(SSD_CHUNK, L)
    n_c = -(-L // q)
    pad = n_c * q - L
    R = SSD_HEADS // SSD_GROUPS
    x_dt = x.astype(f32) * dt[..., None]
    adt = dt * a
    pad_t = lambda t: jnp.pad(t, ((0, 0), (0, pad)) + ((0, 0),) * (t.ndim - 2))
    xc = pad_t(x_dt).reshape(bsz, n_c, q, SSD_GROUPS, R, SSD_HEAD_DIM)
    ac = pad_t(adt).reshape(bsz, n_c, q, SSD_GROUPS, R).transpose(0, 3, 4, 1, 2)
    bc = pad_t(b_in.astype(f32)).reshape(bsz, n_c, q, SSD_GROUPS, SSD_STATE)
    cc = pad_t(c_in.astype(f32)).reshape(bsz, n_c, q, SSD_GROUPS, SSD_STATE)
    a_cs = jnp.cumsum(ac, axis=-1)
    decay = _segsum_decay(a_cs)
    cb = jnp.einsum('bclgn,bcsgn->bgcls', cc, bc)
    y_diag = jnp.einsum('bgcls,bgrcls,bcsgrp->bclgrp', cb, decay, xc)
    decay_states = jnp.exp(a_cs[..., -1:] - a_cs)
    states = jnp.einsum('bcsgn,bgrcs,bcsgrp->cbgrpn', bc, decay_states, xc)
    chunk_decay = jnp.exp(a_cs[..., -1]).transpose(3, 0, 1, 2)
    h_init = h0.astype(f32).reshape(bsz, SSD_GROUPS, R, SSD_HEAD_DIM, SSD_STATE)

    def step(h, inp):
        s, d = inp
        return h * d[..., None, None] + s, h

    h_final, h_prev = lax.scan(step, h_init, (states, chunk_decay))
    y_off = jnp.einsum('bclgn,cbgrpn,bgrcl->bclgrp', cc, h_prev, jnp.exp(a_cs))
    y = (y_diag + y_off).reshape(bsz, n_c * q, SSD_HEADS, SSD_HEAD_DIM)[:, :L]
    return y, h_final.reshape(bsz, SSD_HEADS, SSD_HEAD_DIM, SSD_STATE)


def _mem_attention(q, mem_k, mem_v):
    bsz, L, _ = q.shape
    qh = q.reshape(bsz, L, X_HEADS, X_HEAD_DIM)
    s = jnp.einsum('blhd,bmhd->bhlm', qh, mem_k.astype(q.dtype)).astype(jnp.float32) * (X_HEAD_DIM ** -0.5)
    pr = jax.nn.softmax(s, axis=-1).astype(q.dtype)
    o = jnp.einsum('bhlm,bmhd->blhd', pr, mem_v.astype(q.dtype))
    return o.reshape(bsz, L, D_X)


def _mem_kv(mem, mem_norm_g, w_mem_kv):
    bsz = mem.shape[0]
    kv = _rmsnorm(mem, mem_norm_g) @ w_mem_kv
    k, v = jnp.split(kv, 2, axis=-1)
    return (k.reshape(bsz, N_MEM, X_HEADS, X_HEAD_DIM), v.reshape(bsz, N_MEM, X_HEADS, X_HEAD_DIM))


def _layer(x, mem_k, mem_v, h0, conv0, norm_g, w_in, conv_w, conv_b, dt_bias, a_log, d_skip, ssd_norm_g,
           ln_v_g, ln_v_b, w_spatial, b_spatial, w_proj_a, w_proj_b, w_proj_x, w_out):
    bsz, L, _ = x.shape
    hn = _rmsnorm(x, norm_g)
    proj = hn @ w_in
    u, v, gate_a, z, xbc, dt_raw, q, gate_x, merge = jnp.split(proj, _split_points(IN_SIZES), axis=-1)
    u = jax.nn.gelu(u, approximate=False)
    v = _layernorm(jax.nn.gelu(v, approximate=False), ln_v_g, ln_v_b)
    h_a = u * _gmlp_spatial(v, w_spatial, b_spatial) * jax.nn.silu(gate_a)
    xbc, conv_new = _causal_conv(xbc, conv0, conv_w, conv_b)
    xs, bm, cm = jnp.split(xbc, [D_INNER, D_INNER + SSD_GROUPS * SSD_STATE], axis=-1)
    dt = jax.nn.softplus(dt_raw.astype(jnp.float32) + dt_bias.astype(jnp.float32))
    a = -jnp.exp(a_log.astype(jnp.float32))
    xh = xs.reshape(bsz, L, SSD_HEADS, SSD_HEAD_DIM)
    y, h_new = _ssd(xh, dt, a,
                    bm.reshape(bsz, L, SSD_GROUPS, SSD_STATE),
                    cm.reshape(bsz, L, SSD_GROUPS, SSD_STATE), h0)
    y = y + xh.astype(jnp.float32) * d_skip.astype(jnp.float32)[:, None]
    h_b = _gated_group_rmsnorm(y.reshape(bsz, L, D_INNER).astype(x.dtype), z, ssd_norm_g)
    h_x = _mem_attention(q, mem_k, mem_v) * jax.nn.silu(gate_x)
    g_a, g_b, g_x = jnp.split(jax.nn.sigmoid(merge), N_BRANCH, axis=-1)
    m = g_a * (h_a @ w_proj_a) + g_b * (h_b @ w_proj_b) + g_x * (h_x @ w_proj_x)
    return x + m @ w_out, h_new.astype(h0.dtype), conv_new, v


def setup_inputs(seed: int = 0) -> dict:
    key = jax.random.key(seed)
    ks = jax.random.split(key, 32)
    f32 = jnp.float32
    nrm = lambda k, shape, s: jax.random.normal(k, shape, f32) * s
    Dp = DEPTH
    dt0 = jnp.exp(jax.random.uniform(ks[10], (Dp, SSD_HEADS), f32) * (math.log(0.1) - math.log(0.001)) + math.log(0.001))
    return {
        "x_prompt": nrm(ks[0], (BATCH, SEQ, D_MODEL), 1.0),
        "x_sample": nrm(ks[1], (DEC_BATCH, DEC_SEQ, D_MODEL), 1.0),
        "mem_prompt": nrm(ks[2], (BATCH, N_MEM, D_MODEL), 1.0),
        "cache_mem_k": nrm(ks[3], (Dp, DEC_BATCH, N_MEM, X_HEADS, X_HEAD_DIM), 1.0),
        "cache_mem_v": nrm(ks[4], (Dp, DEC_BATCH, N_MEM, X_HEADS, X_HEAD_DIM), 1.0),
        "state_ssm": nrm(ks[5], (Dp, DEC_BATCH, SSD_HEADS, SSD_HEAD_DIM, SSD_STATE), 0.1),
        "state_conv": nrm(ks[6], (Dp, DEC_BATCH, CONV_W - 1, CONV_DIM), 1.0),
        "norm_g": 1.0 + nrm(ks[7], (Dp, D_MODEL), 0.02),
        "w_in": nrm(ks[8], (Dp, D_MODEL, IN_DIM), D_MODEL ** -0.5),
        "conv_w": nrm(ks[9], (Dp, CONV_W, CONV_DIM), CONV_W ** -0.5),
        "conv_b": nrm(ks[11], (Dp, CONV_DIM), 0.02),
        "dt_bias": dt0 + jnp.log(-jnp.expm1(-dt0)),
        "a_log": jnp.log(jax.random.uniform(ks[12], (Dp, SSD_HEADS), f32, 1.0, 16.0)),
        "d_skip": 1.0 + nrm(ks[13], (Dp, SSD_HEADS), 0.1),
        "ssd_norm_g": 1.0 + nrm(ks[14], (Dp, D_INNER), 0.02),
        "ln_v_g": 1.0 + nrm(ks[15], (Dp, D_A), 0.02),
        "ln_v_b": nrm(ks[16], (Dp, D_A), 0.02),
        "w_spatial": nrm(ks[17], (Dp, A_GROUPS, CHUNK, CHUNK), CHUNK ** -0.5),
        "b_spatial": nrm(ks[18], (Dp, A_GROUPS, CHUNK), 0.02),
        "mem_norm_g": 1.0 + nrm(ks[19], (Dp, D_MODEL), 0.02),
        "w_mem_kv": nrm(ks[20], (Dp, D_MODEL, 2 * D_X), D_MODEL ** -0.5),
        "w_proj_a": nrm(ks[21], (Dp, D_A, D_MODEL), D_A ** -0.5),
        "w_proj_b": nrm(ks[22], (Dp, D_INNER, D_MODEL), D_INNER ** -0.5),
        "w_proj_x": nrm(ks[23], (Dp, D_X, D_MODEL), D_X ** -0.5),
        "w_out": nrm(ks[24], (Dp, D_MODEL, D_MODEL), D_MODEL ** -0.5),
        "final_norm_g": 1.0 + nrm(ks[25], (D_MODEL,), 0.02),
    }


def reference(x_prompt, x_sample, mem_prompt, cache_mem_k, cache_mem_v, state_ssm, state_conv, norm_g, w_in,
              conv_w, conv_b, dt_bias, a_log, d_skip, ssd_norm_g, ln_v_g, ln_v_b, w_spatial, b_spatial,
              mem_norm_g, w_mem_kv, w_proj_a, w_proj_b, w_proj_x, w_out, final_norm_g):
    yp, ys = x_prompt, x_sample
    bsz = x_prompt.shape[0]
    mk_l, mv_l, hp_l, cp_l, hs_l, cs_l, vs_l = [], [], [], [], [], [], []
    for l in range(DEPTH):
        lw = (norm_g[l], w_in[l], conv_w[l], conv_b[l], dt_bias[l], a_log[l], d_skip[l], ssd_norm_g[l],
              ln_v_g[l], ln_v_b[l], w_spatial[l], b_spatial[l], w_proj_a[l], w_proj_b[l], w_proj_x[l], w_out[l])
        mk, mv = _mem_kv(mem_prompt, mem_norm_g[l], w_mem_kv[l])
        h0 = jnp.zeros((bsz, SSD_HEADS, SSD_HEAD_DIM, SSD_STATE), state_ssm.dtype)
        c0 = jnp.zeros((bsz, CONV_W - 1, CONV_DIM), x_prompt.dtype)
        yp, hp, cp, _ = _layer(yp, mk, mv, h0, c0, *lw)
        ys, hs, cs, vs = _layer(ys, cache_mem_k[l], cache_mem_v[l], state_ssm[l], state_conv[l], *lw)
        mk_l.append(mk); mv_l.append(mv); hp_l.append(hp); cp_l.append(cp)
        hs_l.append(hs); cs_l.append(cs); vs_l.append(vs)
    y_prompt = _rmsnorm(yp, final_norm_g)
    y_sample = _rmsnorm(ys, final_norm_g)
    return (y_prompt, y_sample, jnp.stack(mk_l), jnp.stack(mv_l), jnp.stack(hp_l), jnp.stack(cp_l),
            jnp.stack(hs_l), jnp.stack(cs_l), jnp.stack(vs_l))
```

```cpp
#include <hip/hip_runtime.h>
#include <hip/hip_cooperative_groups.h>
#include <cstdio>
namespace cg = cooperative_groups;

#ifndef ONE_LAUNCH
#define ONE_LAUNCH 0
#endif
#ifndef DBG_HB_SCALE
#define DBG_HB_SCALE 1.0f
#endif
#ifndef DBG_MASK
#define DBG_MASK 31
#endif
#ifndef DBG_ITEMS
#define DBG_ITEMS 127
#endif

typedef unsigned short bf16_t;
typedef short bf16x8 __attribute__((ext_vector_type(8)));
typedef float f32x4 __attribute__((ext_vector_type(4)));
typedef float f32x2 __attribute__((ext_vector_type(2)));
typedef unsigned u32x4 __attribute__((ext_vector_type(4)));
typedef unsigned u32x2 __attribute__((ext_vector_type(2)));
#define LAS __attribute__((address_space(3)))

constexpr int MP = 16384, MS = 1024, MT = 17408;
constexpr int IN_DIM = 13344;
constexpr float EPS = 1e-6f;
constexpr int LDS_BYTES = 156 * 1024;

constexpr size_t O_YP = 0, O_YS = 16777216, O_MK = 17825792, O_MV = 18874368, O_HP = 19922944, O_CP = 22020096,
                 O_HS = 22118400, O_CS = 55672832, O_VS = 57245696;

constexpr size_t OFF_A_ALL = 0;
constexpr size_t OFF_BT_ALL = OFF_A_ALL + 39845888;
constexpr size_t OFF_BT_CAT = OFF_BT_ALL + 29360128;
constexpr size_t OFF_BT_OUT = OFF_BT_CAT + 7340032;
constexpr size_t OFF_ACT = OFF_BT_OUT + 2097152;
constexpr size_t OFF_VB = OFF_ACT + 124780544;
constexpr size_t OFF_XBC = OFF_VB + 35651584;
constexpr size_t OFF_QB = OFF_XBC + 142606336;
constexpr size_t OFF_MG = OFF_QB + 17825792;
constexpr size_t OFF_DT = OFF_MG + 106954752;
constexpr size_t OFF_KVB = OFF_DT + 2228224;
constexpr size_t OFF_SSQ = OFF_KVB + 4194304;
constexpr size_t WS_TOTAL = OFF_SSQ + 2228224;
constexpr size_t OFF_M1 = OFF_XBC;
constexpr size_t OFF_M1B = OFF_XBC + 71303168;
constexpr size_t OFF_RSQ = OFF_VB;

struct Params {
    const float *x_prompt, *x_sample, *mem_prompt, *cache_k, *cache_v, *state_ssm, *state_conv, *norm_g, *w_in, *conv_w, *conv_b,
        *dt_bias, *a_log, *d_skip, *ssd_norm_g, *ln_v_g, *ln_v_b, *w_spatial, *b_spatial, *mem_norm_g, *w_mem_kv, *w_proj_a, *w_proj_b,
        *w_proj_x, *w_out, *final_g;
    float* out;
    unsigned char* ws;
};

__device__ __forceinline__ int otid() { int t = threadIdx.x; asm volatile("" : "+v"(t)); return t; }
__device__ __forceinline__ int obid() { int t = blockIdx.x; asm volatile("" : "+s"(t)); return t; }
typedef __bf16 bf16x2_t __attribute__((ext_vector_type(2)));
__device__ __forceinline__ unsigned pk2(float lo, float hi) { const f32x2 v = {lo, hi}; const bf16x2_t b = __builtin_convertvector(v, bf16x2_t); return __builtin_bit_cast(unsigned, b); }
__device__ __forceinline__ float bflo(unsigned w) { return __uint_as_float(w << 16); }
__device__ __forceinline__ float bfhi(unsigned w) { return __uint_as_float(w & 0xffff0000u); }
__device__ __forceinline__ float bf2f(bf16_t b) { return __uint_as_float(((unsigned)b) << 16); }
__device__ __forceinline__ float bfe(const u32x4& v, int e) { const unsigned w = v[e >> 1]; return (e & 1) ? bfhi(w) : bflo(w); }
__device__ __forceinline__ unsigned bfe16(const u32x4& v, int e) { const unsigned w = v[e >> 1]; return (e & 1) ? (w >> 16) : (w & 0xffffu); }
__device__ __forceinline__ float fsigmoid(float x) { return __builtin_amdgcn_rcpf(1.0f + __builtin_amdgcn_exp2f(-1.44269504f * x)); }
__device__ __forceinline__ float fsilu(float x) { return x * fsigmoid(x); }
__device__ __forceinline__ float fexp(float x) { return __builtin_amdgcn_exp2f(1.44269504f * x); }
__device__ __forceinline__ f32x4 mfma16(bf16x8 a, bf16x8 b, f32x4 c) { return __builtin_amdgcn_mfma_f32_16x16x32_bf16(a, b, c, 0, 0, 0); }
__device__ __forceinline__ bf16x8 as_bf16x8(u32x4 v) { return __builtin_bit_cast(bf16x8, v); }
__device__ __forceinline__ u32x4 pk8(f32x4 a, f32x4 b) { return (u32x4){pk2(a[0], a[1]), pk2(a[2], a[3]), pk2(b[0], b[1]), pk2(b[2], b[3])}; }
__device__ __forceinline__ f32x2 gelu_pk(f32x2 v) {
    const f32x2 av = __builtin_elementwise_abs(v), d = av * 0.2316418882f + 1.0f;
    f32x2 t; t.x = __builtin_amdgcn_rcpf(d.x); t.y = __builtin_amdgcn_rcpf(d.y);
    f32x2 q = t * 0.5307027145f + (-0.7265760135f); q = q * t + 0.7107068705f; q = q * t + (-0.142248368f); q = q * t + 0.127414796f; q = q * t;
    const f32x2 s = (v * v) * (-0.72134752044f);
    f32x2 e; e.x = __builtin_amdgcn_exp2f(s.x); e.y = __builtin_amdgcn_exp2f(s.y);
    const f32x2 m = v * (q * e), r = v - m;
    f32x2 o; o.x = v.x < 0.f ? m.x : r.x; o.y = v.y < 0.f ? m.y : r.y; return o;
}
__device__ __forceinline__ f32x4 gelu4(f32x4 v) { f32x2 a = gelu_pk((f32x2){v[0], v[1]}), b = gelu_pk((f32x2){v[2], v[3]}); return (f32x4){a.x, a.y, b.x, b.y}; }
__device__ __forceinline__ f32x4 silu4(f32x4 v) { return (f32x4){fsilu(v[0]), fsilu(v[1]), fsilu(v[2]), fsilu(v[3])}; }
__device__ __forceinline__ f32x4 sigm4(f32x4 v) { return (f32x4){fsigmoid(v[0]), fsigmoid(v[1]), fsigmoid(v[2]), fsigmoid(v[3])}; }
__device__ __forceinline__ f32x4 bf4lo(u32x2 w) { return (f32x4){bflo(w[0]), bfhi(w[0]), bflo(w[1]), bfhi(w[1])}; }

namespace pg8 {
constexpr int BM = 256, BK = 64, HALF = 128, HTB = HALF * BK * 2, NXCD = 8, WGM = 8;
__device__ __forceinline__ int lds_byte(int r, int c) { const int st = (r >> 4) * 2 + (c >> 5), rr = r & 15, cc = c & 31, ob = rr * 64 + cc * 2; return st * 1024 + (ob ^ (((ob >> 9) & 1) << 5)); }
__device__ __forceinline__ void stage_rc(int b, int& R, int& C) { const int st = b / 1024, sb = b % 1024, swz = sb ^ (((sb >> 9) & 1) << 5); R = (st >> 1) * 16 + swz / 64; C = (st & 1) * 32 + (swz % 64) / 2; }
__device__ __forceinline__ int perm32(int rho) { const int n = rho >> 4, i = rho & 15; return 8 * (i >> 2) + 4 * n + (i & 3); }
struct Unit { int pm, pn; };
struct Desc { const bf16_t* A; const bf16_t* Bt; int lda, ldb, K, kind, mode; };

struct Sched {
    int kind, G, c;
    __device__ __forceinline__ static void smap(long L, int nM, int nN, Unit& u) {
        const int nwg = nM * nN; int wgid = (int)L;
        { const int q = nwg / NXCD, r = nwg % NXCD, xcd = wgid % NXCD, off = wgid / NXCD; wgid = (xcd < r ? xcd * (q + 1) : r * (q + 1) + (xcd - r) * q) + off; }
        const int nig = WGM * nN, gid = wgid / nig, fm = gid * WGM, gsz = (nM - fm) < WGM ? (nM - fm) : WGM;
        u.pm = fm + ((wgid % nig) % gsz); u.pn = (wgid % nig) / gsz;
    }
    __device__ __forceinline__ bool next(int i, Unit& u) const {
        const long L = (long)i * G + c;
        if (kind == 0) {
            if (L < 3536) { smap(L, 68, 52, u); return true; }
            if (L < 3568) { const int j = (int)L - 3536; u.pm = 68 + (j >> 2); u.pn = 52 + (j & 3); return true; }
            return false;
        }
        if (L < 272) { smap(L, 68, 4, u); return true; }
        return false;
    }
};

template <int ACT> __device__ __forceinline__ void epi_unary(const f32x4 (&acc)[2][2][4][2], bf16_t* base, size_t ld, int row0, int col0, float scale) {
#pragma unroll
    for (int ai = 0; ai < 2; ++ai)
#pragma unroll
        for (int m = 0; m < 4; ++m) {
            bf16_t* rp = base + (size_t)(row0 + ai * HALF + m * 16) * ld + col0;
#pragma unroll
            for (int bj = 0; bj < 2; ++bj) {
                f32x4 v0 = acc[ai][bj][m][0], v1 = acc[ai][bj][m][1];
                if (ACT == 1) { v0 = gelu4(v0); v1 = gelu4(v1); }
                if (ACT == 2) { v0 = silu4(v0); v1 = silu4(v1); }
                if (ACT == 3) { v0 = sigm4(v0); v1 = sigm4(v1); }
                if (ACT == 4) { v0 = v0 * scale; v1 = v1 * scale; }
                *(u32x4*)(rp + bj * HALF) = pk8(v0, v1);
            }
        }
}

__device__ __forceinline__ void epilogue(const f32x4 (&acc)[2][2][4][2], const Unit& u, int wr, int wc, int fr, int fq, const Params& p, int mode) {
    const int row0 = u.pm * BM + wr * 64 + fr, cl = wc * 32 + 8 * fq;
    unsigned char* ws = p.ws;
    if (mode == 0) {
        const int pn = u.pn;
        if (pn < 8) {
            bf16_t* base = (bf16_t*)(ws + OFF_ACT);
#pragma unroll
            for (int ai = 0; ai < 2; ++ai)
#pragma unroll
                for (int m = 0; m < 4; ++m) {
                    f32x4 u0 = gelu4(acc[ai][0][m][0]), u1 = gelu4(acc[ai][0][m][1]);
                    f32x4 g0 = silu4(acc[ai][1][m][0]), g1 = silu4(acc[ai][1][m][1]);
                    *(u32x4*)(base + (size_t)(row0 + ai * HALF + m * 16) * 3584 + pn * 128 + cl) = pk8(u0 * g0, u1 * g1);
                }
        } else if (pn < 12) epi_unary<1>(acc, (bf16_t*)(ws + OFF_VB), 1024, row0, (pn - 8) * 256 + cl, 1.f);
        else if (pn < 20) epi_unary<2>(acc, (bf16_t*)(ws + OFF_ACT), 3584, row0, 1024 + (pn - 12) * 256 + cl, 1.f);
        else if (pn < 36) epi_unary<0>(acc, (bf16_t*)(ws + OFF_XBC), 4096, row0, (pn - 20) * 256 + cl, 1.f);
        else if (pn < 38) epi_unary<4>(acc, (bf16_t*)(ws + OFF_QB), 512, row0, (pn - 36) * 256 + cl, 0.08838834764831845f * 1.4426950408889634f);
        else if (pn < 40) epi_unary<2>(acc, (bf16_t*)(ws + OFF_ACT), 3584, row0, 3072 + (pn - 38) * 256 + cl, 1.f);
        else if (pn < 52) epi_unary<3>(acc, (bf16_t*)(ws + OFF_MG), 3072, row0, (pn - 40) * 256 + cl, 1.f);
        else {
            const int isv = pn >= 54, ct = (pn - (isv ? 54 : 52)) * 256 + cl, r0 = row0 - MT;
            float* of = p.out + (isv ? O_MV : O_MK);
            bf16_t* ob = (bf16_t*)(ws + OFF_KVB) + (isv ? 2048 * 512 : 0);
#pragma unroll
            for (int ai = 0; ai < 2; ++ai)
#pragma unroll
                for (int m = 0; m < 4; ++m) {
                    const size_t ro = (size_t)(r0 + ai * HALF + m * 16) * 512 + ct;
#pragma unroll
                    for (int bj = 0; bj < 2; ++bj) {
                        const f32x4 v0 = acc[ai][bj][m][0], v1 = acc[ai][bj][m][1];
                        *(f32x4*)(of + ro + bj * HALF) = v0; *(f32x4*)(of + ro + bj * HALF + 4) = v1;
                        *(u32x4*)(ob + ro + bj * HALF) = pk8(v0, v1);
                    }
                }
        }
    } else if (mode <= 3) {
        const bf16_t* mg = (const bf16_t*)(ws + OFF_MG) + (mode - 1) * 1024;
        float* m1 = (float*)(ws + OFF_M1);
        bf16_t* m1b = (bf16_t*)(ws + OFF_M1B);
        const int c0 = u.pn * 256 + cl;
#pragma unroll
        for (int ai = 0; ai < 2; ++ai)
#pragma unroll
            for (int m = 0; m < 4; ++m) {
                const size_t row = (size_t)(row0 + ai * HALF + m * 16);
#pragma unroll
                for (int bj = 0; bj < 2; ++bj) {
                    const u32x4 gw = *(const u32x4*)(mg + row * 3072 + c0 + bj * HALF);
                    f32x4 v0 = acc[ai][bj][m][0] * bf4lo((u32x2){gw[0], gw[1]}), v1 = acc[ai][bj][m][1] * bf4lo((u32x2){gw[2], gw[3]});
                    float* mp = m1 + row * 1024 + c0 + bj * HALF;
                    if (mode >= 2) { v0 += *(const f32x4*)mp; v1 += *(const f32x4*)(mp + 4); }
                    if (mode <= 2) { *(f32x4*)mp = v0; *(f32x4*)(mp + 4) = v1; }
                    else *(u32x4*)(m1b + row * 1024 + c0 + bj * HALF) = pk8(v0, v1);
                }
            }
    } else {
        const float* xs = (u.pm < 64) ? p.x_prompt : (p.x_sample - (size_t)MP * 1024);
        float* rsq = (float*)(ws + OFF_RSQ);
        const int c0 = u.pn * 256 + cl;
#pragma unroll
        for (int ai = 0; ai < 2; ++ai)
#pragma unroll
            for (int m = 0; m < 4; ++m) {
                const size_t row = (size_t)(row0 + ai * HALF + m * 16);
                float ss = 0.f;
#pragma unroll
                for (int bj = 0; bj < 2; ++bj) {
                    const size_t o = row * 1024 + c0 + bj * HALF;
                    const f32x4 v0 = acc[ai][bj][m][0] + *(const f32x4*)(xs + o), v1 = acc[ai][bj][m][1] + *(const f32x4*)(xs + o + 4);
                    *(f32x4*)(p.out + o) = v0; *(f32x4*)(p.out + o + 4) = v1;
                    ss += v0[0] * v0[0] + v0[1] * v0[1] + v0[2] * v0[2] + v0[3] * v0[3] + v1[0] * v1[0] + v1[1] * v1[1] + v1[2] * v1[2] + v1[3] * v1[3];
                }
                ss += __shfl_xor(ss, 16); ss += __shfl_xor(ss, 32);
                if (fq == 0) atomicAdd(rsq + row, ss);
            }
    }
}

__device__ __forceinline__ void gemm_phase(LAS unsigned char* lds, const Desc g, const Sched& S, const Params& P) {
    const int tid = otid(), wid = __builtin_amdgcn_readfirstlane(tid >> 6), lane = tid & 63, wr = wid >> 2, wc = wid & 3, fr = lane & 15, fq = lane >> 4;
    const int nt = g.K / BK;
    unsigned voffA[2], voffB[2];
#pragma unroll
    for (int i = 0; i < 2; ++i) { int R, C; stage_rc(tid * 16 + i * 8192, R, C); const int Rb = (R & ~31) + perm32(R & 31);
        voffA[i] = (unsigned)(R * g.lda + C) * 2u; voffB[i] = (unsigned)(Rb * g.ldb + C) * 2u; }
    const size_t kstep = (size_t)(BK * 2);
    const size_t hstepA = (size_t)HALF * g.lda * 2, hstepB = (size_t)HALF * g.ldb * 2;
    const size_t tstepA = 2 * hstepA, tstepB = 2 * hstepB;
    const unsigned ldsw = (unsigned)wid * 1024u;
    const int aoff = lds_byte(wr * 64 + fr, fq * 8), boff = lds_byte(wc * 32 + fr, fq * 8);
#define PG8_SA(b, h) (((b) * 2 + (h)) * HTB)
#define PG8_SB(b, h) ((4 + (b) * 2 + (h)) * HTB)
#define PG8_STAGE(bufoff, gbase, voff) do { _Pragma("unroll") for (int _i = 0; _i < 2; ++_i) \
        __builtin_amdgcn_global_load_lds((const unsigned*)((const char*)(gbase) + (voff)[_i]), (LAS unsigned*)(lds + (bufoff) + ldsw + _i * 8192), 16, 0, 0); } while (0)
#define PG8_LDA(dst, b, h) do { _Pragma("unroll") for (int m = 0; m < 4; ++m) _Pragma("unroll") for (int k = 0; k < 2; ++k) dst[m][k] = *(const LAS bf16x8*)(lds + PG8_SA(b, h) + aoff + m * 2048 + k * 1024); } while (0)
#define PG8_LDB(dst, b, h) do { _Pragma("unroll") for (int n = 0; n < 2; ++n) _Pragma("unroll") for (int k = 0; k < 2; ++k) dst[n][k] = *(const LAS bf16x8*)(lds + PG8_SB(b, h) + boff + n * 2048 + k * 1024); } while (0)
#define PG8_MMA(ai, bj, At, Bt) do { __builtin_amdgcn_s_setprio(1); _Pragma("unroll") for (int m = 0; m < 4; ++m) _Pragma("unroll") for (int n = 0; n < 2; ++n) _Pragma("unroll") for (int k = 0; k < 2; ++k) \
        acc[ai][bj][m][n] = __builtin_amdgcn_mfma_f32_16x16x32_bf16(Bt[n][k], At[m][k], acc[ai][bj][m][n], 0, 0, 0); __builtin_amdgcn_s_setprio(0); } while (0)
#define PG8_WAIT_V(n) asm volatile("s_waitcnt vmcnt(" #n ")" ::: "memory")
#define PG8_WAIT_L(n) asm volatile("s_waitcnt lgkmcnt(" #n ")" ::: "memory")
#define PG8_BAR __builtin_amdgcn_s_barrier()
#define PG8_SCHED __builtin_amdgcn_sched_barrier(0)
    Unit cur, nxt; int ui = 0;
    if (!S.next(0, cur)) return;
    f32x4 acc[2][2][4][2];
#pragma unroll
    for (int a = 0; a < 2; ++a)
#pragma unroll
        for (int b = 0; b < 2; ++b)
#pragma unroll
            for (int m = 0; m < 4; ++m)
#pragma unroll
                for (int n = 0; n < 2; ++n) acc[a][b][m][n] = (f32x4){0.f, 0.f, 0.f, 0.f};
    bf16x8 At[4][2], B0[2][2], B1[2][2];
    const char* cA = (const char*)g.A + (size_t)cur.pm * tstepA; const char* cB = (const char*)g.Bt + (size_t)cur.pn * tstepB;
    PG8_STAGE(PG8_SB(0, 0), cB, voffB); PG8_STAGE(PG8_SA(0, 0), cA, voffA); PG8_STAGE(PG8_SB(0, 1), cB + hstepB, voffB); PG8_STAGE(PG8_SA(0, 1), cA + hstepA, voffA);
    if (wr == 1) PG8_BAR;
    PG8_WAIT_V(4); PG8_BAR;
    PG8_STAGE(PG8_SB(1, 0), cB + kstep, voffB); PG8_STAGE(PG8_SA(1, 0), cA + kstep, voffA); PG8_STAGE(PG8_SB(1, 1), cB + hstepB + kstep, voffB);
    PG8_WAIT_V(6); PG8_BAR;
    for (;;) {
        const bool has_next = S.next(ui + 1, nxt);
        const char* nA = has_next ? (const char*)g.A + (size_t)nxt.pm * tstepA : cA; const char* nB = has_next ? (const char*)g.Bt + (size_t)nxt.pn * tstepB : cB;
        for (int t = 0; t < nt; t += 2) {
            const bool last = (t == nt - 2);
            const char* a1 = cA + (size_t)(t + 1) * kstep;
            const char* a2 = last ? nA : cA + (size_t)(t + 2) * kstep; const char* b2 = last ? nB : cB + (size_t)(t + 2) * kstep;
            const char* a3 = a2 + kstep; const char* b3 = b2 + kstep;
            PG8_LDB(B0, 0, 0); PG8_SCHED; PG8_LDA(At, 0, 0); PG8_STAGE(PG8_SA(1, 1), a1 + hstepA, voffA);
            PG8_WAIT_L(8); PG8_BAR; PG8_WAIT_L(0); PG8_MMA(0, 0, At, B0); PG8_BAR; PG8_SCHED;
            PG8_LDB(B1, 0, 1); PG8_STAGE(PG8_SB(0, 0), b2, voffB);
            PG8_BAR; PG8_WAIT_L(0); PG8_MMA(0, 1, At, B1); PG8_BAR;
            PG8_LDA(At, 0, 1); PG8_STAGE(PG8_SA(0, 0), a2, voffA);
            PG8_BAR; PG8_WAIT_L(0); PG8_MMA(1, 0, At, B0); PG8_BAR; PG8_SCHED;
            PG8_STAGE(PG8_SB(0, 1), b2 + hstepB, voffB);
            PG8_WAIT_V(6); PG8_BAR; PG8_MMA(1, 1, At, B1); PG8_BAR;
            PG8_LDB(B0, 1, 0); PG8_SCHED; PG8_LDA(At, 1, 0); PG8_STAGE(PG8_SA(0, 1), a2 + hstepA, voffA);
            PG8_WAIT_L(8); PG8_BAR; PG8_WAIT_L(0); PG8_MMA(0, 0, At, B0); PG8_BAR; PG8_SCHED;
            PG8_LDB(B1, 1, 1); PG8_STAGE(PG8_SB(1, 0), b3, voffB);
            PG8_BAR; PG8_WAIT_L(0); PG8_MMA(0, 1, At, B1); PG8_BAR;
            PG8_LDA(At, 1, 1); PG8_STAGE(PG8_SA(1, 0), a3, voffA);
            PG8_BAR; PG8_WAIT_L(0); PG8_MMA(1, 0, At, B0); PG8_BAR; PG8_SCHED;
            PG8_STAGE(PG8_SB(1, 1), b3 + hstepB, voffB);
            PG8_WAIT_V(6); PG8_BAR; PG8_MMA(1, 1, At, B1); PG8_BAR;
        }
        epilogue(acc, cur, wr, wc, fr, fq, P, g.mode);
        if (!has_next) break;
#pragma unroll
        for (int a = 0; a < 2; ++a)
#pragma unroll
            for (int b = 0; b < 2; ++b)
#pragma unroll
                for (int m = 0; m < 4; ++m)
#pragma unroll
                    for (int n = 0; n < 2; ++n) acc[a][b][m][n] = (f32x4){0.f, 0.f, 0.f, 0.f};
        cur = nxt; cA = nA; cB = nB; ++ui;
    }
    PG8_WAIT_V(0);
    if (wr == 0) PG8_BAR;
    PG8_BAR;
#undef PG8_SA
#undef PG8_SB
#undef PG8_STAGE
#undef PG8_LDA
#undef PG8_LDB
#undef PG8_MMA
#undef PG8_WAIT_V
#undef PG8_WAIT_L
#undef PG8_BAR
#undef PG8_SCHED
}
}

__device__ __forceinline__ int in_srccol(int nb) {
    if (nb < 16) return (nb & 1) ? 2048 + (nb >> 1) * 128 : (nb >> 1) * 128;
    if (nb < 24) return 1024 + (nb - 16) * 128;
    if (nb < 40) return 3072 + (nb - 24) * 128;
    if (nb < 72) return 5120 + (nb - 40) * 128;
    if (nb < 76) return 9248 + (nb - 72) * 128;
    if (nb < 80) return 9760 + (nb - 76) * 128;
    return 10272 + (nb - 80) * 128;
}

__device__ __forceinline__ void phase0(const Params& p, unsigned char* smem) {
    const int tid = otid(), lane = tid & 63, wid = tid >> 6, l15 = lane & 15, kq = lane >> 4;
    unsigned char* ws = p.ws;
    bf16x8 bw[4][2];
#pragma unroll
    for (int s = 0; s < 4; ++s)
#pragma unroll
        for (int nt = 0; nt < 2; ++nt) {
            const float* wp = p.w_in + (size_t)(128 * wid + 32 * s + 8 * kq) * IN_DIM + 9216 + 16 * nt + l15;
            u32x4 v;
#pragma unroll
            for (int i = 0; i < 4; ++i) v[i] = pk2(wp[(size_t)(2 * i) * IN_DIM], wp[(size_t)(2 * i + 1) * IN_DIM]);
            bw[s][nt] = as_bf16x8(v);
        }
    float* tile = (float*)smem;
    bf16_t* hn = (bf16_t*)smem;
    float* part = (float*)(smem + 33280);
    for (int it = obid(); it < 3584; it += gridDim.x) {
        if (it < 2368) {
            const float* src; int ldsrc, k0, sc0, ldd, dr0, dc0; bf16_t* dst; const float* scl = nullptr;
            if (it < 1664) { const int kb = it & 15, nb = it >> 4; src = p.w_in; ldsrc = IN_DIM; k0 = kb * 64; sc0 = in_srccol(nb); dst = (bf16_t*)(ws + OFF_BT_ALL); ldd = 1024; dr0 = nb * 128; dc0 = k0; }
            else if (it < 1792) { const int j = it - 1664, kb = j & 15, nb = j >> 4; src = p.w_mem_kv; ldsrc = 1024; k0 = kb * 64; sc0 = nb * 128; dst = (bf16_t*)(ws + OFF_BT_ALL); ldd = 1024; dr0 = 13312 + nb * 128; dc0 = k0; }
            else if (it < 1920) { const int j = it - 1792, kb = j & 15, nb = j >> 4; src = p.w_proj_a; ldsrc = 1024; k0 = kb * 64; sc0 = nb * 128; dst = (bf16_t*)(ws + OFF_BT_CAT); ldd = 3584; dr0 = nb * 128; dc0 = k0; }
            else if (it < 2176) { const int j = it - 1920, kb = j & 31, nb = j >> 5; src = p.w_proj_b; ldsrc = 1024; k0 = kb * 64; sc0 = nb * 128; dst = (bf16_t*)(ws + OFF_BT_CAT); ldd = 3584; dr0 = nb * 128; dc0 = 1024 + k0; scl = p.ssd_norm_g; }
            else if (it < 2240) { const int j = it - 2176, kb = j & 7, nb = j >> 3; src = p.w_proj_x; ldsrc = 1024; k0 = kb * 64; sc0 = nb * 128; dst = (bf16_t*)(ws + OFF_BT_CAT); ldd = 3584; dr0 = nb * 128; dc0 = 3072 + k0; }
            else { const int j = it - 2240, kb = j & 15, nb = j >> 4; src = p.w_out; ldsrc = 1024; k0 = kb * 64; sc0 = nb * 128; dst = (bf16_t*)(ws + OFF_BT_OUT); ldd = 1024; dr0 = nb * 128; dc0 = k0; }
            const int c4 = tid & 31, kr = tid >> 5;
#pragma unroll
            for (int i = 0; i < 4; ++i) {
                const int k = kr + 16 * i;
                f32x4 v = *(const f32x4*)(src + (size_t)(k0 + k) * ldsrc + sc0 + 4 * c4);
                if (scl) v = v * scl[k0 + k];
                *(f32x4*)(tile + k * 132 + 4 * c4) = v;
            }
            __syncthreads();
            const int n = tid & 127, kc = tid >> 7;
            u32x4 o0, o1;
#pragma unroll
            for (int j = 0; j < 4; ++j) {
                o0[j] = pk2(tile[(16 * kc + 2 * j) * 132 + n], tile[(16 * kc + 2 * j + 1) * 132 + n]);
                o1[j] = pk2(tile[(16 * kc + 8 + 2 * j) * 132 + n], tile[(16 * kc + 8 + 2 * j + 1) * 132 + n]);
            }
            bf16_t* dp = dst + (size_t)(dr0 + n) * ldd + dc0 + 16 * kc;
            *(u32x4*)dp = o0; *(u32x4*)(dp + 8) = o1;
            __syncthreads();
        } else {
            const int j = it - 2368;
            const float* src; const float* gam; int drow; bool do_dt;
            if (j < 1088) { const int r0 = 16 * j; src = (r0 < MP) ? p.x_prompt + (size_t)r0 * 1024 : p.x_sample + (size_t)(r0 - MP) * 1024; gam = p.norm_g; drow = r0; do_dt = true; }
            else { const int r0 = 16 * (j - 1088); src = p.mem_prompt + (size_t)r0 * 1024; gam = p.mem_norm_g; drow = MT + r0; do_dt = false; }
            bf16_t* adst = (bf16_t*)(ws + OFF_A_ALL);
#pragma unroll
            for (int rr = 0; rr < 2; ++rr) {
                const int r = 2 * wid + rr;
                f32x4 v[4]; float ss = 0.f;
#pragma unroll
                for (int i = 0; i < 4; ++i) { v[i] = *(const f32x4*)(src + (size_t)r * 1024 + 4 * lane + 256 * i); ss += v[i][0] * v[i][0] + v[i][1] * v[i][1] + v[i][2] * v[i][2] + v[i][3] * v[i][3]; }
#pragma unroll
                for (int o = 1; o < 64; o <<= 1) ss += __shfl_xor(ss, o);
                const float sc = __builtin_amdgcn_rsqf(ss * (1.0f / 1024.0f) + EPS);
#pragma unroll
                for (int i = 0; i < 4; ++i) {
                    const f32x4 gv = *(const f32x4*)(gam + 4 * lane + 256 * i);
                    const f32x4 y = v[i] * sc * gv;
                    const u32x2 pkd = (u32x2){pk2(y[0], y[1]), pk2(y[2], y[3])};
                    *(u32x2*)(adst + (size_t)(drow + r) * 1024 + 4 * lane + 256 * i) = pkd;
                    *(u32x2*)(hn + r * 1032 + 4 * lane + 256 * i) = pkd;
                }
            }
            __syncthreads();
            if (do_dt) {
                f32x4 a0 = {0.f, 0.f, 0.f, 0.f}, a1 = {0.f, 0.f, 0.f, 0.f};
#pragma unroll
                for (int s = 0; s < 4; ++s) {
                    const bf16x8 af = *(const bf16x8*)(hn + l15 * 1032 + 128 * wid + 32 * s + 8 * kq);
                    a0 = mfma16(af, bw[s][0], a0); a1 = mfma16(af, bw[s][1], a1);
                }
#pragma unroll
                for (int r = 0; r < 4; ++r) { part[(wid * 16 + 4 * kq + r) * 32 + l15] = a0[r]; part[(wid * 16 + 4 * kq + r) * 32 + 16 + l15] = a1[r]; }
                __syncthreads();
                const int row = tid >> 5, col = tid & 31;
                float s = p.dt_bias[col];
#pragma unroll
                for (int w8 = 0; w8 < 8; ++w8) s += part[(w8 * 16 + row) * 32 + col];
                const float sp = (s > 20.f) ? s : log1pf(__expf(s));
                ((float*)(ws + OFF_DT))[(size_t)(drow + row) * 32 + col] = sp;
            }
            __syncthreads();
        }
    }
}

__device__ __forceinline__ void ssd_prompt_item(const Params& p, unsigned char* smem, int b, int h) {
    const int tid = otid(), lane = tid & 63, w = tid >> 6, l15 = lane & 15, kq = lane >> 4;
    bf16_t* sC = (bf16_t*)smem; bf16_t* sB = sC + 128 * 136; bf16_t* sBdT = sB + 128 * 136; bf16_t* sXT = sBdT + 128 * 136; bf16_t* sH = sXT + 64 * 136;
    float* sAcs = (float*)(sH + 64 * 136); float* sDt = sAcs + 2048;
    const int g = h >> 2;
    const float a = -__expf(p.a_log[h]), Dh = p.d_skip[h];
    const size_t rowb = (size_t)b * 2048;
    const bf16_t* XBC = (const bf16_t*)(p.ws + OFF_XBC);
    bf16_t* ACT = (bf16_t*)(p.ws + OFF_ACT);
    const float* DT = (const float*)(p.ws + OFF_DT);
    float* SSQ = (float*)(p.ws + OFF_SSQ);
    {
        const int t = tid * 4;
        const float d0 = DT[(rowb + t) * 32 + h], d1 = DT[(rowb + t + 1) * 32 + h], d2 = DT[(rowb + t + 2) * 32 + h], d3 = DT[(rowb + t + 3) * 32 + h];
        const float s0 = d0 * a, s1 = s0 + d1 * a, s2 = s1 + d2 * a, s3 = s2 + d3 * a;
        float run = s3;
#pragma unroll
        for (int o = 1; o < 32; o <<= 1) { const float v = __shfl_up(run, o, 32); if ((lane & 31) >= o) run += v; }
        const float ex = run - s3;
        *(f32x4*)(sAcs + t) = (f32x4){ex + s0, ex + s1, ex + s2, ex + s3};
        *(f32x4*)(sDt + t) = (f32x4){d0, d1, d2, d3};
    }
    for (int i = tid; i < 64 * 136 / 2; i += 512) ((unsigned*)sH)[i] = 0u;
    f32x4 hacc[4];
#pragma unroll
    for (int i = 0; i < 4; ++i) hacc[i] = (f32x4){0.f, 0.f, 0.f, 0.f};
    __syncthreads();
#pragma unroll 1
    for (int c = 0; c < 16; ++c) {
        const int t0 = c * 128;
        const float acs_last = sAcs[t0 + 127];
#pragma unroll 1
        for (int task = tid; task < 640; task += 512) {
            int kind, cc, seg, col;
            if (task < 128) { kind = 0; cc = task & 7; seg = task >> 3; col = h * 64 + 8 * cc; }
            else if (task < 384) { kind = 1; const int q = task - 128; cc = q & 15; seg = q >> 4; col = 2048 + g * 128 + 8 * cc; }
            else { kind = 2; const int q = task - 384; cc = q & 15; seg = q >> 4; col = 3072 + g * 128 + 8 * cc; }
            const int tb = t0 + 8 * seg;
            u32x4 raw[11];
#pragma unroll
            for (int i = 0; i < 11; ++i) { const int t = tb - 3 + i; raw[i] = (t >= 0) ? *(const u32x4*)(XBC + (rowb + t) * 4096 + col) : (u32x4){0u, 0u, 0u, 0u}; }
            float o[8][8];
#pragma unroll
            for (int e4 = 0; e4 < 2; ++e4) {
                const f32x4 w0 = *(const f32x4*)(p.conv_w + col + 4 * e4), w1 = *(const f32x4*)(p.conv_w + 4096 + col + 4 * e4),
                            w2 = *(const f32x4*)(p.conv_w + 8192 + col + 4 * e4), w3 = *(const f32x4*)(p.conv_w + 12288 + col + 4 * e4),
                            bv = *(const f32x4*)(p.conv_b + col + 4 * e4);
#pragma unroll
                for (int ee = 0; ee < 4; ++ee) {
                    const int e = 4 * e4 + ee;
                    float x[11];
#pragma unroll
                    for (int i = 0; i < 11; ++i) x[i] = bfe(raw[i], e);
#pragma unroll
                    for (int j = 0; j < 8; ++j) o[j][e] = fsilu(bv[ee] + w0[ee] * x[j] + w1[ee] * x[j + 1] + w2[ee] * x[j + 2] + w3[ee] * x[j + 3]);
                }
            }
            if (kind == 0) {
#pragma unroll
                for (int e = 0; e < 8; ++e)
                    *(u32x4*)(sXT + (8 * cc + e) * 136 + 8 * seg) = (u32x4){pk2(o[0][e], o[1][e]), pk2(o[2][e], o[3][e]), pk2(o[4][e], o[5][e]), pk2(o[6][e], o[7][e])};
            } else if (kind == 1) {
                float wg[8];
#pragma unroll
                for (int j = 0; j < 8; ++j) {
                    *(u32x4*)(sB + (8 * seg + j) * 136 + 8 * cc) = (u32x4){pk2(o[j][0], o[j][1]), pk2(o[j][2], o[j][3]), pk2(o[j][4], o[j][5]), pk2(o[j][6], o[j][7])};
                    wg[j] = fexp(acs_last - sAcs[tb + j]) * sDt[tb + j];
                }
#pragma unroll
                for (int e = 0; e < 8; ++e)
                    *(u32x4*)(sBdT + (8 * cc + e) * 136 + 8 * seg) = (u32x4){pk2(o[0][e] * wg[0], o[1][e] * wg[1]), pk2(o[2][e] * wg[2], o[3][e] * wg[3]),
                                                                            pk2(o[4][e] * wg[4], o[5][e] * wg[5]), pk2(o[6][e] * wg[6], o[7][e] * wg[7])};
            } else {
#pragma unroll
                for (int j = 0; j < 8; ++j)
                    *(u32x4*)(sC + (8 * seg + j) * 136 + 8 * cc) = (u32x4){pk2(o[j][0], o[j][1]), pk2(o[j][2], o[j][3]), pk2(o[j][4], o[j][5]), pk2(o[j][6], o[j][7])};
            }
        }
        __syncthreads();
        {
            const float cd = fexp(acs_last);
#pragma unroll
            for (int pt = 0; pt < 4; ++pt) hacc[pt] = hacc[pt] * cd;
#pragma unroll
            for (int ks = 0; ks < 4; ++ks) {
                const bf16x8 af = *(const bf16x8*)(sBdT + (16 * w + l15) * 136 + 32 * ks + 8 * kq);
#pragma unroll
                for (int pt = 0; pt < 4; ++pt) hacc[pt] = mfma16(af, *(const bf16x8*)(sXT + (16 * pt + l15) * 136 + 32 * ks + 8 * kq), hacc[pt]);
            }
        }
        {
            bf16x8 cf[4];
#pragma unroll
            for (int ks = 0; ks < 4; ++ks) cf[ks] = *(const bf16x8*)(sC + (16 * w + l15) * 136 + 32 * ks + 8 * kq);
            const int lrow = 16 * w + l15;
            const float my_acs = sAcs[t0 + lrow];
            f32x4 yd[4];
#pragma unroll
            for (int pt = 0; pt < 4; ++pt) yd[pt] = (f32x4){0.f, 0.f, 0.f, 0.f};
            const int npair = (w >> 1) + 1;
#pragma unroll 1
            for (int j = 0; j < npair; ++j) {
                f32x4 gt[2];
#pragma unroll
                for (int hh = 0; hh < 2; ++hh) {
                    const int st = 2 * j + hh;
                    f32x4 cb = {0.f, 0.f, 0.f, 0.f};
                    if (st <= w) {
#pragma unroll
                        for (int ks = 0; ks < 4; ++ks) cb = mfma16(*(const bf16x8*)(sB + (16 * st + l15) * 136 + 32 * ks + 8 * kq), cf[ks], cb);
                        const int s0 = 16 * st + 4 * kq;
                        const f32x4 as = *(const f32x4*)(sAcs + t0 + s0), ds = *(const f32x4*)(sDt + t0 + s0);
#pragma unroll
                        for (int r = 0; r < 4; ++r) cb[r] = (s0 + r <= lrow) ? cb[r] * fexp(my_acs - as[r]) * ds[r] : 0.f;
                    }
                    gt[hh] = cb;
                }
                const bf16x8 gp = as_bf16x8(pk8(gt[0], gt[1]));
#pragma unroll
                for (int pt = 0; pt < 4; ++pt) {
                    const u32x2 x0 = *(const u32x2*)(sXT + (16 * pt + l15) * 136 + 32 * j + 4 * kq), x1 = *(const u32x2*)(sXT + (16 * pt + l15) * 136 + 32 * j + 16 + 4 * kq);
                    yd[pt] = mfma16(as_bf16x8((u32x4){x0[0], x0[1], x1[0], x1[1]}), gp, yd[pt]);
                }
            }
            const float ea = fexp(my_acs);
            const size_t grow = rowb + t0 + lrow;
            float ss = 0.f;
#pragma unroll
            for (int pt = 0; pt < 4; ++pt) {
                f32x4 yo = {0.f, 0.f, 0.f, 0.f};
#pragma unroll
                for (int ks = 0; ks < 4; ++ks) yo = mfma16(*(const bf16x8*)(sH + (16 * pt + l15) * 136 + 32 * ks + 8 * kq), cf[ks], yo);
                bf16_t* zp = ACT + grow * 3584 + 1024 + h * 64 + 16 * pt + 4 * kq;
                const f32x4 zs = bf4lo(*(const u32x2*)zp);
                f32x4 y;
#pragma unroll
                for (int r = 0; r < 4; ++r) { const float xv = bf2f(sXT[(16 * pt + 4 * kq + r) * 136 + lrow]); y[r] = (yd[pt][r] + ea * yo[r] + Dh * xv) * zs[r]; ss += y[r] * y[r]; }
                *(u32x2*)zp = (u32x2){pk2(y[0], y[1]), pk2(y[2], y[3])};
            }
            ss += __shfl_xor(ss, 16); ss += __shfl_xor(ss, 32);
            if (kq == 0) SSQ[grow * 32 + h] = ss;
        }
        __syncthreads();
#pragma unroll
        for (int pt = 0; pt < 4; ++pt) *(u32x2*)(sH + (16 * pt + l15) * 136 + 16 * w + 4 * kq) = (u32x2){pk2(hacc[pt][0], hacc[pt][1]), pk2(hacc[pt][2], hacc[pt][3])};
    }
    float* hp = p.out + O_HP + ((size_t)(b * 32 + h) * 64) * 128;
#pragma unroll
    for (int pt = 0; pt < 4; ++pt) *(f32x4*)(hp + (size_t)(16 * pt + l15) * 128 + 16 * w + 4 * kq) = hacc[pt];
    __syncthreads();
}

__device__ __forceinline__ float conv_col_tok(const float (&x)[11], float bias, float w0, float w1, float w2, float w3, int t) { return fsilu(bias + w0 * x[t] + w1 * x[t + 1] + w2 * x[t + 2] + w3 * x[t + 3]); }
__device__ __forceinline__ void ssd_sample_item(const Params& p, unsigned char* smem, int b, int oct) {
    const int tid = otid(), lane = tid & 63, w = tid >> 6, l15 = lane & 15, kq = lane >> 4;
    float* sBs = (float*)smem; float* sCs = sBs + 2048; float* sXs = sCs + 2048; float* sW = sXs + 4096;
    const bf16_t* XBC = (const bf16_t*)(p.ws + OFF_XBC);
    bf16_t* ACT = (bf16_t*)(p.ws + OFF_ACT);
    const float* DT = (const float*)(p.ws + OFF_DT);
    float* SSQ = (float*)(p.ws + OFF_SSQ);
    const int h = 8 * oct + w, gi = w >> 2;
    const size_t row0 = (size_t)MP + 8 * b;
#pragma unroll
    for (int pass = 0; pass < 2; ++pass) {
        int col; float* dst;
        if (pass == 0) { const int gi2 = tid >> 8, ci = tid & 255; col = (ci < 128) ? 2048 + (2 * oct + gi2) * 128 + ci : 3072 + (2 * oct + gi2) * 128 + (ci - 128);
            dst = (ci < 128) ? sBs + gi2 * 1024 + ci : sCs + gi2 * 1024 + (ci - 128); }
        else { col = 512 * oct + tid; dst = sXs + w * 512 + lane; }
        float x[11];
#pragma unroll
        for (int i = 0; i < 3; ++i) x[i] = p.state_conv[((size_t)b * 3 + i) * 4096 + col];
#pragma unroll
        for (int t = 0; t < 8; ++t) x[3 + t] = bf2f(XBC[(row0 + t) * 4096 + col]);
        const float w0 = p.conv_w[col], w1 = p.conv_w[4096 + col], w2 = p.conv_w[8192 + col], w3 = p.conv_w[12288 + col], bias = p.conv_b[col];
        const int ts = (pass == 0) ? 128 : 64;
#pragma unroll
        for (int t = 0; t < 8; ++t) dst[t * ts] = conv_col_tok(x, bias, w0, w1, w2, w3, t);
    }
    __syncthreads();
    const float a = -__expf(p.a_log[h]), Dh = p.d_skip[h];
    float dtv[8], acs[8];
    { float run = 0.f;
#pragma unroll
      for (int t = 0; t < 8; ++t) { dtv[t] = DT[(row0 + t) * 32 + h]; run += dtv[t] * a; acs[t] = run; } }
    {
        const int t = lane >> 3, s = lane & 7;
        float m = 0.f;
        const f32x4* cp = (const f32x4*)(sCs + gi * 1024 + t * 128); const f32x4* bp = (const f32x4*)(sBs + gi * 1024 + s * 128);
#pragma unroll 8
        for (int n4 = 0; n4 < 32; ++n4) { const f32x4 c4 = cp[n4], b4 = bp[n4]; m += c4[0] * b4[0] + c4[1] * b4[1] + c4[2] * b4[2] + c4[3] * b4[3]; }
        float at = 0.f, as = 0.f, dts = 0.f;
#pragma unroll
        for (int i = 0; i < 8; ++i) { if (i == t) at = acs[i]; if (i == s) { as = acs[i]; dts = dtv[i]; } }
        sW[w * 64 + lane] = (s <= t) ? m * fexp(at - as) * dts : 0.f;
    }
    __syncthreads();
    const float* hsrc = p.state_ssm + ((size_t)(b * 32 + h) * 64) * 128;
    float* hdst = p.out + O_HS + ((size_t)(b * 32 + h) * 64) * 128;
    const bool tv = l15 < 8;
    bf16x8 cfr[4];
#pragma unroll
    for (int ks = 0; ks < 4; ++ks) {
        const float* q = sCs + gi * 1024 + (l15 & 7) * 128 + 32 * ks + 8 * kq;
        const f32x4 c0 = *(const f32x4*)q, c1 = *(const f32x4*)(q + 4);
        cfr[ks] = tv ? as_bf16x8(pk8(c0, c1)) : as_bf16x8((u32x4){0u, 0u, 0u, 0u});
    }
    float at = 0.f;
#pragma unroll
    for (int i = 0; i < 8; ++i) if (i == l15) at = acs[i];
    const float eat = fexp(at);
    float wrow[8];
    { const f32x4 w0 = *(const f32x4*)(sW + w * 64 + (l15 & 7) * 8), w1 = *(const f32x4*)(sW + w * 64 + (l15 & 7) * 8 + 4);
#pragma unroll
      for (int s = 0; s < 4; ++s) { wrow[s] = w0[s] + ((s == l15) ? Dh : 0.f); wrow[4 + s] = w1[s] + ((4 + s == l15) ? Dh : 0.f); } }
    const float ea7 = fexp(acs[7]);
    float coef[8];
#pragma unroll
    for (int s = 0; s < 8; ++s) coef[s] = dtv[s] * fexp(acs[7] - acs[s]);
    float ss = 0.f;
#pragma unroll 1
    for (int pt = 0; pt < 4; ++pt) {
        f32x4 hr[4][2];
#pragma unroll
        for (int ks = 0; ks < 4; ++ks) { const float* q = hsrc + (size_t)(16 * pt + l15) * 128 + 32 * ks + 8 * kq; hr[ks][0] = *(const f32x4*)q; hr[ks][1] = *(const f32x4*)(q + 4); }
        f32x4 y0 = {0.f, 0.f, 0.f, 0.f};
#pragma unroll
        for (int ks = 0; ks < 4; ++ks) y0 = mfma16(as_bf16x8(pk8(hr[ks][0], hr[ks][1])), cfr[ks], y0);
        const int p0 = 16 * pt + 4 * kq;
        f32x4 y = y0 * eat;
#pragma unroll
        for (int s = 0; s < 8; ++s) y += *(const f32x4*)(sXs + w * 512 + s * 64 + p0) * wrow[s];
        if (tv) {
            bf16_t* zp = ACT + (row0 + l15) * 3584 + 1024 + h * 64 + p0;
            const f32x4 zs = bf4lo(*(const u32x2*)zp);
            y = y * zs;
            ss += y[0] * y[0] + y[1] * y[1] + y[2] * y[2] + y[3] * y[3];
            *(u32x2*)zp = (u32x2){pk2(y[0], y[1]), pk2(y[2], y[3])};
        }
        float xw[8];
#pragma unroll
        for (int s = 0; s < 8; ++s) xw[s] = coef[s] * sXs[w * 512 + s * 64 + 16 * pt + l15];
#pragma unroll
        for (int ks = 0; ks < 4; ++ks) {
            f32x4 n0 = hr[ks][0] * ea7, n1 = hr[ks][1] * ea7;
#pragma unroll
            for (int s = 0; s < 8; ++s) { const float* q = sBs + gi * 1024 + s * 128 + 32 * ks + 8 * kq; n0 += *(const f32x4*)q * xw[s]; n1 += *(const f32x4*)(q + 4) * xw[s]; }
            float* d = hdst + (size_t)(16 * pt + l15) * 128 + 32 * ks + 8 * kq;
            *(f32x4*)d = n0; *(f32x4*)(d + 4) = n1;
            __builtin_amdgcn_sched_barrier(0);
        }
    }
    ss += __shfl_xor(ss, 16); ss += __shfl_xor(ss, 32);
    if (tv && kq == 0) SSQ[(row0 + l15) * 32 + h] = ss;
    __syncthreads();
}

__device__ __forceinline__ void attn_item(const Params& p, unsigned char* smem, bool sample, int b, int head, int qblk) {
    const int tid = otid(), lane = tid & 63, w = tid >> 6, l15 = lane & 15, kq = lane >> 4;
    bf16_t* sK = (bf16_t*)smem;
    bf16_t* sVt = sK + 256 * 136;
    const bf16_t* QB = (const bf16_t*)(p.ws + OFF_QB);
    bf16_t* ACT = (bf16_t*)(p.ws + OFF_ACT);
    if (!sample) {
        const bf16_t* Kb = (const bf16_t*)(p.ws + OFF_KVB) + (size_t)(b * 256) * 512 + head * 128;
        const bf16_t* Vb = Kb + (size_t)2048 * 512;
#pragma unroll
        for (int i = 0; i < 8; ++i) { const int q = tid + 512 * i, key = q >> 4, dc = q & 15; *(u32x4*)(sK + key * 136 + 8 * dc) = *(const u32x4*)(Kb + (size_t)key * 512 + 8 * dc); }
#pragma unroll
        for (int i = 0; i < 2; ++i) {
            const int q = tid + 512 * i, dc = q & 15, kk = q >> 4;
            u32x4 rv[4];
#pragma unroll
            for (int j = 0; j < 4; ++j) rv[j] = *(const u32x4*)(Vb + (size_t)(4 * kk + j) * 512 + 8 * dc);
#pragma unroll
            for (int e = 0; e < 8; ++e)
                *(u32x2*)(sVt + (8 * dc + e) * 264 + 4 * kk) = (u32x2){bfe16(rv[0], e) | (bfe16(rv[1], e) << 16), bfe16(rv[2], e) | (bfe16(rv[3], e) << 16)};
        }
    } else {
        const float* Kf = p.cache_k + ((size_t)(b * 256) * 4 + head) * 128;
        const float* Vf = p.cache_v + ((size_t)(b * 256) * 4 + head) * 128;
#pragma unroll
        for (int i = 0; i < 8; ++i) { const int q = tid + 512 * i, key = q >> 4, dc = q & 15; const float* s = Kf + (size_t)key * 512 + 8 * dc;
            *(u32x4*)(sK + key * 136 + 8 * dc) = pk8(*(const f32x4*)s, *(const f32x4*)(s + 4)); }
#pragma unroll
        for (int i = 0; i < 2; ++i) {
            const int q = tid + 512 * i, dc = q & 15, kk = q >> 4;
            f32x4 r0[4], r1[4];
#pragma unroll
            for (int j = 0; j < 4; ++j) { const float* s = Vf + (size_t)(4 * kk + j) * 512 + 8 * dc; r0[j] = *(const f32x4*)s; r1[j] = *(const f32x4*)(s + 4); }
#pragma unroll
            for (int e = 0; e < 4; ++e) {
                *(u32x2*)(sVt + (8 * dc + e) * 264 + 4 * kk) = (u32x2){pk2(r0[0][e], r0[1][e]), pk2(r0[2][e], r0[3][e])};
                *(u32x2*)(sVt + (8 * dc + 4 + e) * 264 + 4 * kk) = (u32x2){pk2(r1[0][e], r1[1][e]), pk2(r1[2][e], r1[3][e])};
            }
        }
    }
    __syncthreads();
    const int nqt = sample ? (w == 0 ? 1 : 0) : 2;
#pragma unroll 1
    for (int qt = 0; qt < nqt; ++qt) {
        const bool valid = sample ? (l15 < 8) : true;
        const size_t rowq = sample ? ((size_t)MP + 8 * b + (l15 & 7)) : ((size_t)b * 2048 + qblk * 256 + 32 * w + 16 * qt + l15);
        bf16x8 qf[4];
#pragma unroll
        for (int ks = 0; ks < 4; ++ks) { u32x4 v = *(const u32x4*)(QB + rowq * 512 + head * 128 + 32 * ks + 8 * kq); if (!valid) v = (u32x4){0u, 0u, 0u, 0u}; qf[ks] = as_bf16x8(v); }
        f32x4 st[16];
#pragma unroll
        for (int kt = 0; kt < 16; ++kt) {
            f32x4 acc = {0.f, 0.f, 0.f, 0.f};
#pragma unroll
            for (int ks = 0; ks < 4; ++ks) acc = mfma16(*(const bf16x8*)(sK + (16 * kt + l15) * 136 + 32 * ks + 8 * kq), qf[ks], acc);
            st[kt] = acc;
            if (kt & 1) __builtin_amdgcn_sched_barrier(0);
        }
        float mx = -3.0e38f;
#pragma unroll
        for (int kt = 0; kt < 16; ++kt) mx = fmaxf(mx, fmaxf(fmaxf(st[kt][0], st[kt][1]), fmaxf(st[kt][2], st[kt][3])));
        mx = fmaxf(mx, __shfl_xor(mx, 16)); mx = fmaxf(mx, __shfl_xor(mx, 32));
        float sum = 0.f;
#pragma unroll
        for (int kt = 0; kt < 16; ++kt)
#pragma unroll
            for (int r = 0; r < 4; ++r) { const float e = __builtin_amdgcn_exp2f(st[kt][r] - mx); st[kt][r] = e; sum += e; }
        sum += __shfl_xor(sum, 16); sum += __shfl_xor(sum, 32);
        const float inv = __builtin_amdgcn_rcpf(sum);
        f32x4 o[8];
#pragma unroll
        for (int dt = 0; dt < 8; ++dt) o[dt] = (f32x4){0.f, 0.f, 0.f, 0.f};
#pragma unroll
        for (int j = 0; j < 8; ++j) {
            const bf16x8 pk = as_bf16x8(pk8(st[2 * j], st[2 * j + 1]));
#pragma unroll
            for (int dt = 0; dt < 8; ++dt) {
                const u32x2 a0 = *(const u32x2*)(sVt + (16 * dt + l15) * 264 + 32 * j + 4 * kq), a1 = *(const u32x2*)(sVt + (16 * dt + l15) * 264 + 32 * j + 16 + 4 * kq);
                o[dt] = mfma16(as_bf16x8((u32x4){a0[0], a0[1], a1[0], a1[1]}), pk, o[dt]);
            }
            __builtin_amdgcn_sched_barrier(0);
        }
        if (valid) {
#pragma unroll
            for (int dt = 0; dt < 8; ++dt) {
                bf16_t* gp = ACT + rowq * 3584 + 3072 + head * 128 + 16 * dt + 4 * kq;
                const f32x4 gx = bf4lo(*(const u32x2*)gp);
                const f32x4 v = o[dt] * inv * gx;
                *(u32x2*)gp = (u32x2){pk2(v[0], v[1]), pk2(v[2], v[3])};
            }
        }
    }
    __syncthreads();
}

__device__ __forceinline__ void spatial_prompt_item(const Params& p, unsigned char* smem, int b, int c, int half) {
    const int tid = otid(), lane = tid & 63, w = tid >> 6, l15 = lane & 15, kq = lane >> 4;
    float* sStat = (float*)smem;
    bf16_t* sW = (bf16_t*)(smem + 1024);
    bf16_t* sVT = sW + 128 * 136;
    const bf16_t* VB = (const bf16_t*)(p.ws + OFF_VB);
    bf16_t* ACT = (bf16_t*)(p.ws + OFF_ACT);
    const size_t r0 = (size_t)b * 2048 + c * 128;
#pragma unroll 1
    for (int rr = 0; rr < 16; ++rr) {
        const int r = 16 * w + rr;
        const u32x4 v0 = *(const u32x4*)(VB + (r0 + r) * 1024 + 8 * lane), v1 = *(const u32x4*)(VB + (r0 + r) * 1024 + 512 + 8 * lane);
        float s = 0.f, q = 0.f;
#pragma unroll
        for (int e = 0; e < 8; ++e) { const float a0 = bfe(v0, e), a1 = bfe(v1, e); s += a0 + a1; q += a0 * a0 + a1 * a1; }
#pragma unroll
        for (int o = 1; o < 64; o <<= 1) { s += __shfl_xor(s, o); q += __shfl_xor(q, o); }
        if (lane == 0) { const float mean = s * (1.f / 1024.f); const float var = fmaxf(q * (1.f / 1024.f) - mean * mean, 0.f); sStat[2 * r] = mean; sStat[2 * r + 1] = __builtin_amdgcn_rsqf(var + EPS); }
    }
    __syncthreads();
#pragma unroll 1
    for (int gg = 0; gg < 4; ++gg) {
        const int g = 4 * half + gg;
#pragma unroll
        for (int i = 0; i < 4; ++i) {
            const int q = tid + 512 * i, t = q >> 4, sc = q & 15;
            const float* wp = p.w_spatial + ((size_t)g * 128 + t) * 128 + 8 * sc;
            f32x4 a0 = *(const f32x4*)wp, a1 = *(const f32x4*)(wp + 4);
#pragma unroll
            for (int e = 0; e < 4; ++e) { if (8 * sc + e > t) a0[e] = 0.f; if (8 * sc + 4 + e > t) a1[e] = 0.f; }
            *(u32x4*)(sW + t * 136 + 8 * sc) = pk8(a0, a1);
        }
        {
            const int dc = tid & 15, sk = tid >> 4;
            const f32x4 g0 = *(const f32x4*)(p.ln_v_g + g * 128 + 8 * dc), g1 = *(const f32x4*)(p.ln_v_g + g * 128 + 8 * dc + 4);
            const f32x4 b0 = *(const f32x4*)(p.ln_v_b + g * 128 + 8 * dc), b1 = *(const f32x4*)(p.ln_v_b + g * 128 + 8 * dc + 4);
            float vn[4][8];
#pragma unroll
            for (int j = 0; j < 4; ++j) {
                const int s = 4 * sk + j;
                const u32x4 rv = *(const u32x4*)(VB + (r0 + s) * 1024 + g * 128 + 8 * dc);
                const float mean = sStat[2 * s], rstd = sStat[2 * s + 1];
#pragma unroll
                for (int e = 0; e < 8; ++e) vn[j][e] = (bfe(rv, e) - mean) * rstd * (e < 4 ? g0[e & 3] : g1[e & 3]) + (e < 4 ? b0[e & 3] : b1[e & 3]);
            }
#pragma unroll
            for (int e = 0; e < 8; ++e) *(u32x2*)(sVT + (8 * dc + e) * 136 + 4 * sk) = (u32x2){pk2(vn[0][e], vn[1][e]), pk2(vn[2][e], vn[3][e])};
        }
        __syncthreads();
        {
            f32x4 acc[8];
#pragma unroll
            for (int dt = 0; dt < 8; ++dt) acc[dt] = (f32x4){0.f, 0.f, 0.f, 0.f};
            const int nks = (w >> 1) + 1;
#pragma unroll 1
            for (int ks = 0; ks < nks; ++ks) {
                const bf16x8 wf = *(const bf16x8*)(sW + (16 * w + l15) * 136 + 32 * ks + 8 * kq);
#pragma unroll
                for (int dt = 0; dt < 8; ++dt) acc[dt] = mfma16(*(const bf16x8*)(sVT + (16 * dt + l15) * 136 + 32 * ks + 8 * kq), wf, acc[dt]);
            }
            const int t = 16 * w + l15;
            const float bs = p.b_spatial[g * 128 + t];
#pragma unroll
            for (int dt = 0; dt < 8; ++dt) {
                bf16_t* up = ACT + (r0 + t) * 3584 + g * 128 + 16 * dt + 4 * kq;
                const f32x4 ug = bf4lo(*(const u32x2*)up);
                const f32x4 v = ug * (acc[dt] + bs);
                *(u32x2*)up = (u32x2){pk2(v[0], v[1]), pk2(v[2], v[3])};
            }
        }
        __syncthreads();
    }
}

__device__ __forceinline__ void spatial_sample_item(const Params& p, unsigned char* smem, int b) {
    const int tid = otid(), lane = tid & 63, w = tid >> 6;
    float* sRed = (float*)smem;
    const bf16_t* VB = (const bf16_t*)(p.ws + OFF_VB);
    bf16_t* ACT = (bf16_t*)(p.ws + OFF_ACT);
    const size_t r0 = (size_t)MP + 8 * b;
    const int c = 2 * tid;
    float v[8][2];
#pragma unroll
    for (int t = 0; t < 8; ++t) {
        const unsigned wv = *(const unsigned*)(VB + (r0 + t) * 1024 + c);
        v[t][0] = bflo(wv); v[t][1] = bfhi(wv);
        float s = v[t][0] + v[t][1], q = v[t][0] * v[t][0] + v[t][1] * v[t][1];
#pragma unroll
        for (int o = 1; o < 64; o <<= 1) { s += __shfl_xor(s, o); q += __shfl_xor(q, o); }
        if (lane == 0) { sRed[(w * 8 + t) * 2] = s; sRed[(w * 8 + t) * 2 + 1] = q; }
    }
    __syncthreads();
    const float g0 = p.ln_v_g[c], g1 = p.ln_v_g[c + 1], b0 = p.ln_v_b[c], b1 = p.ln_v_b[c + 1];
    float* vout = p.out + O_VS + (size_t)b * 8 * 1024;
#pragma unroll
    for (int t = 0; t < 8; ++t) {
        float s = 0.f, q = 0.f;
#pragma unroll
        for (int ww = 0; ww < 8; ++ww) { s += sRed[(ww * 8 + t) * 2]; q += sRed[(ww * 8 + t) * 2 + 1]; }
        const float mean = s * (1.f / 1024.f), rstd = __builtin_amdgcn_rsqf(fmaxf(q * (1.f / 1024.f) - mean * mean, 0.f) + EPS);
        v[t][0] = (v[t][0] - mean) * rstd * g0 + b0; v[t][1] = (v[t][1] - mean) * rstd * g1 + b1;
        *(f32x2*)(vout + t * 1024 + c) = (f32x2){v[t][0], v[t][1]};
    }
    const int g = w;
#pragma unroll
    for (int t = 0; t < 8; ++t) {
        float s0 = p.b_spatial[g * 128 + t], s1 = s0;
#pragma unroll
        for (int s = 0; s <= t; ++s) { const float ws_ = p.w_spatial[((size_t)g * 128 + t) * 128 + s]; s0 += ws_ * v[s][0]; s1 += ws_ * v[s][1]; }
        unsigned* up = (unsigned*)(ACT + (r0 + t) * 3584 + c);
        const unsigned uw = *up;
        *up = pk2(bflo(uw) * s0, bfhi(uw) * s1);
    }
    __syncthreads();
}

__device__ __forceinline__ void conv_copy_item(const Params& p, int j) {
    const bf16_t* XBC = (const bf16_t*)(p.ws + OFF_XBC);
    const size_t srow = (j < 8) ? ((size_t)j * 2048 + 2045) : ((size_t)MP + 8 * (j - 8) + 5);
    float* dst = (j < 8) ? p.out + O_CP + (size_t)j * 3 * 4096 : p.out + O_CS + (size_t)(j - 8) * 3 * 4096;
    for (int i = otid(); i < 3 * 4096; i += 512) dst[i] = bf2f(XBC[srow * 4096 + i]);
}

__device__ __forceinline__ void phase2(const Params& p, unsigned char* smem) {
#pragma unroll 1
    for (int it = obid(); it < 2056; it += gridDim.x) {
        if (it < 256) { if (DBG_ITEMS & 1) ssd_prompt_item(p, smem, it >> 5, it & 31); }
        else if (it < 512) { const int j = it - 256; if (DBG_ITEMS & 2) attn_item(p, smem, false, j >> 5, (j >> 3) & 3, j & 7); }
        else if (it < 768) { const int j = it - 512; if (DBG_ITEMS & 4) spatial_prompt_item(p, smem, j >> 5, (j >> 1) & 15, j & 1); }
        else if (it < 1280) { const int j = it - 768; if (DBG_ITEMS & 8) ssd_sample_item(p, smem, j >> 2, j & 3); }
        else if (it < 1792) { const int j = it - 1280; if (DBG_ITEMS & 16) attn_item(p, smem, true, j >> 2, j & 3, 0); }
        else if (it < 1920) { if (DBG_ITEMS & 32) spatial_sample_item(p, smem, it - 1792); }
        else conv_copy_item(p, it - 1920);
    }
}

__device__ __forceinline__ void phase3(const Params& p) {
    bf16_t* ACT = (bf16_t*)(p.ws + OFF_ACT);
    const float* SSQ = (const float*)(p.ws + OFF_SSQ);
    float* rsq = (float*)(p.ws + OFF_RSQ);
    const size_t gt = (size_t)obid() * 512 + otid(), gs = (size_t)gridDim.x * 512;
    for (size_t i = gt; i < (size_t)MT; i += gs) rsq[i] = 0.f;
    for (size_t i = gt; i < (size_t)MT * 256; i += gs) {
        const size_t row = i >> 8; const int ch = (int)(i & 255), g = ch >> 5;
        const f32x4 s4 = *(const f32x4*)(SSQ + row * 32 + 4 * g);
        const float sc = DBG_HB_SCALE * __builtin_amdgcn_rsqf((s4[0] + s4[1] + s4[2] + s4[3]) * (1.f / 256.f) + EPS);
        u32x4* q = (u32x4*)(ACT + row * 3584 + 1024 + 8 * ch);
        const u32x4 v = *q;
        *q = (u32x4){pk2(bflo(v[0]) * sc, bfhi(v[0]) * sc), pk2(bflo(v[1]) * sc, bfhi(v[1]) * sc), pk2(bflo(v[2]) * sc, bfhi(v[2]) * sc), pk2(bflo(v[3]) * sc, bfhi(v[3]) * sc)};
    }
}

__device__ __forceinline__ void phase_final(const Params& p) {
    const float* rsq = (const float*)(p.ws + OFF_RSQ);
    const size_t gt = (size_t)obid() * 512 + otid(), gs = (size_t)gridDim.x * 512;
    for (size_t i = gt; i < (size_t)MT * 256; i += gs) {
        const size_t row = i >> 8; const int c4 = (int)(i & 255);
        const float sc = __builtin_amdgcn_rsqf(rsq[row] * (1.f / 1024.f) + EPS);
        f32x4* q = (f32x4*)(p.out + row * 1024 + 4 * c4);
        *q = *q * sc * *(const f32x4*)(p.final_g + 4 * c4);
    }
}

constexpr int NSTEPS = 9;
__global__ void __launch_bounds__(512, 2) k_main(Params p, int s0, int s1) {
    extern __shared__ __attribute__((aligned(16))) unsigned char smem[];
#if ONE_LAUNCH
    cg::grid_group grid = cg::this_grid();
#endif
#pragma unroll 1
    for (int step = s0; step < s1; ++step) {
        if (step == 0) { if (DBG_MASK & 1) phase0(p, smem); }
        else if (step == 2) { if (DBG_MASK & 2) phase2(p, smem); }
        else if (step == 3) { if (DBG_MASK & 4) phase3(p); }
        else if (step == 8) { if (DBG_MASK & 8) phase_final(p); }
        else if (DBG_MASK & 16) {
            pg8::Desc g;
            unsigned char* ws = p.ws;
            if (step == 1) { g.A = (const bf16_t*)(ws + OFF_A_ALL); g.Bt = (const bf16_t*)(ws + OFF_BT_ALL); g.lda = 1024; g.ldb = 1024; g.K = 1024; g.kind = 0; g.mode = 0; }
            else if (step == 4) { g.A = (const bf16_t*)(ws + OFF_ACT); g.Bt = (const bf16_t*)(ws + OFF_BT_CAT); g.lda = 3584; g.ldb = 3584; g.K = 1024; g.kind = 1; g.mode = 1; }
            else if (step == 5) { g.A = (const bf16_t*)(ws + OFF_ACT) + 1024; g.Bt = (const bf16_t*)(ws + OFF_BT_CAT) + 1024; g.lda = 3584; g.ldb = 3584; g.K = 2048; g.kind = 1; g.mode = 2; }
            else if (step == 6) { g.A = (const bf16_t*)(ws + OFF_ACT) + 3072; g.Bt = (const bf16_t*)(ws + OFF_BT_CAT) + 3072; g.lda = 3584; g.ldb = 3584; g.K = 512; g.kind = 1; g.mode = 3; }
            else { g.A = (const bf16_t*)(ws + OFF_M1B); g.Bt = (const bf16_t*)(ws + OFF_BT_OUT); g.lda = 1024; g.ldb = 1024; g.K = 1024; g.kind = 1; g.mode = 4; }
            pg8::Sched S; S.kind = g.kind; S.G = (int)gridDim.x; S.c = obid();
            pg8::gemm_phase((LAS unsigned char*)smem, g, S, p);
            __syncthreads();
        }
#if ONE_LAUNCH
        if (step + 1 < s1 && step != 4 && step != 5) grid.sync();
#endif
    }
}

#ifndef DBG_SCALE_MASK
#define DBG_SCALE_MASK 0
#endif
__global__ void k_dbg_scale(float* out, int mask) {
    const size_t offs[10] = {O_YP, O_YS, O_MK, O_MV, O_HP, O_CP, O_HS, O_CS, O_VS, 58294272};
    for (int k = 0; k < 9; ++k) if (mask & (1 << k))
        for (size_t i = offs[k] + (size_t)blockIdx.x * blockDim.x + threadIdx.x; i < offs[k + 1]; i += (size_t)gridDim.x * blockDim.x) out[i] *= 3.0f;
}

extern "C" void kernel_launch(void* const* d_in, const int* in_sizes, int n_in, void* d_out, int out_size, void* d_ws, size_t ws_size, hipStream_t stream) {
    static int grid_blocks = 0;
    if (!grid_blocks) {
        int dev = 0, cus = 0, per_cu = 0;
        hipGetDevice(&dev);
        hipDeviceGetAttribute(&cus, hipDeviceAttributeMultiprocessorCount, dev);
        hipFuncSetAttribute((const void*)k_main, hipFuncAttributeMaxDynamicSharedMemorySize, LDS_BYTES);
        hipOccupancyMaxActiveBlocksPerMultiprocessor(&per_cu, k_main, 512, LDS_BYTES);
        if (per_cu < 1) per_cu = 1;
        grid_blocks = cus * per_cu;
        if (grid_blocks > 256) grid_blocks = 256;
    }
    if (ws_size < WS_TOTAL) fprintf(stderr, "workspace too small: %zu < %zu\n", ws_size, WS_TOTAL);
    Params p{};
    const float** pf = (const float**)&p;
    for (int i = 0; i < 26; ++i) pf[i] = (const float*)d_in[i];
    p.out = (float*)d_out; p.ws = (unsigned char*)d_ws;
#if ONE_LAUNCH
    int s0 = 0, s1 = NSTEPS;
    void* args[] = {&p, &s0, &s1};
    hipError_t e = hipLaunchCooperativeKernel((const void*)k_main, dim3(grid_blocks), dim3(512), args, LDS_BYTES, stream);
    if (e != hipSuccess) fprintf(stderr, "cooperative launch failed: %s (grid %d)\n", hipGetErrorString(e), grid_blocks);
#else
    const int cuts[8] = {0, 1, 2, 3, 4, 7, 8, 9};
    for (int i = 0; i < 7; ++i) k_main<<<grid_blocks, 512, LDS_BYTES, stream>>>(p, cuts[i], cuts[i + 1]);
    if (DBG_SCALE_MASK) k_dbg_scale<<<1024, 256, 0, stream>>>((float*)d_out, DBG_SCALE_MASK);
#endif
}
```
